# Optimizing an MI355X kernel written in HIP

```python
import jax, jax.numpy as jnp
from jax import lax
import numpy as np

D_MODEL = 1024
BATCH = 8
SEQ = 4096
DEPTH = 2

N_EVEN = (DEPTH + 1) // 2
N_ODD = DEPTH // 2

GM_WIDTH = 512
GM_HEADS = 8
GM_HEAD_DIM = GM_WIDTH // GM_HEADS
CHUNK = 128
POOL_WIDTH = 512
POOL_WINDOWS = (2, 4, 8, 16)
POOL_GROUPS = len(POOL_WINDOWS)
POOL_GROUP_DIM = POOL_WIDTH // POOL_GROUPS
EVEN_IN = 2 * GM_WIDTH + POOL_WIDTH
EVEN_MIX = GM_WIDTH + POOL_WIDTH
MLA_HEADS = 16
QK_NOPE = 64
QK_ROPE = 32
V_HEAD = 64
Q_LORA = 384
KV_LORA = 256
ODD_IN = Q_LORA + KV_LORA + QK_ROPE
ROPE_THETA = 10000.0
Q_BLOCK = 128
_FF_RAW = -(-8 * D_MODEL // 3)
D_FF = -(-_FF_RAW // 256) * 256
ALPHA = (2 * DEPTH) ** 0.25
BETA = (8 * DEPTH) ** -0.25
LN_EPS = 1e-5
RMS_EPS = 1e-6

kernel_name = "hybrid_gmlp_pool_mla_deepnorm"


def layer_norm(x, g, b):
    xf = x.astype(jnp.float32)
    mu = xf.mean(-1, keepdims=True)
    var = jnp.square(xf - mu).mean(-1, keepdims=True)
    return ((xf - mu) * lax.rsqrt(var + LN_EPS) * g + b).astype(x.dtype)


def rms_norm(x, g):
    xf = x.astype(jnp.float32)
    return (xf * lax.rsqrt(jnp.square(xf).mean(-1, keepdims=True) + RMS_EPS) * g).astype(x.dtype)


def chunked_spatial_gating(z, vnorm_g, vnorm_b, w_s, b_s):
    bsz, s, _ = z.shape
    u, v = z[..., :GM_WIDTH], z[..., GM_WIDTH:]
    v = layer_norm(v, vnorm_g, vnorm_b)
    v = v.reshape(bsz, s // CHUNK, CHUNK, GM_HEADS, GM_HEAD_DIM)
    causal = jnp.tril(jnp.ones((CHUNK, CHUNK), dtype=bool))
    w = jnp.where(causal[None], w_s, 0)
    mixed = jnp.einsum('hts,bcshd->bcthd', w, v) + b_s.T[None, None, :, :, None]
    return u * mixed.reshape(bsz, s, GM_WIDTH)


def multiscale_pool(xp, w_pool, scale):
    bsz, s, _ = xp.shape
    xf = xp.astype(jnp.float32).reshape(bsz, s, POOL_GROUPS, POOL_GROUP_DIM)
    csum = jnp.concatenate([jnp.zeros_like(xf[:, :1]), jnp.cumsum(xf, axis=1)], axis=1)
    t = jnp.arange(s)
    outs = []
    for g, w in enumerate(POOL_WINDOWS):
        c = csum[:, :, g]
        upper = c[:, 1:]
        lower = jnp.concatenate([jnp.zeros_like(c[:, :w - 1]), c[:, :s + 1 - w]], axis=1)
        count = jnp.minimum(t + 1, w).astype(jnp.float32)[None, :, None]
        outs.append((upper - lower) / count - xf[:, :, g])
    pooled = jnp.stack(outs, axis=2).astype(xp.dtype)
    mixed = jnp.einsum('bsgc,gcd->bsgd', pooled, w_pool).reshape(bsz, s, POOL_WIDTH)
    return mixed * scale


def even_mixer(x, w_in, vnorm_g, vnorm_b, w_s, b_s, w_pool, pool_scale, w_out):
    h = x @ w_in
    a = chunked_spatial_gating(jax.nn.gelu(h[..., :2 * GM_WIDTH], approximate=False),
                               vnorm_g, vnorm_b, w_s, b_s)
    bp = multiscale_pool(h[..., 2 * GM_WIDTH:], w_pool, pool_scale)
    return jnp.concatenate([a, bp], axis=-1) @ w_out


def apply_rope(x, cos, sin):
    xf = x.astype(jnp.float32)
    half = xf.shape[-1] // 2
    x1, x2 = xf[..., :half], xf[..., half:]
    return jnp.concatenate([x1 * cos - x2 * sin, x1 * sin + x2 * cos], axis=-1).astype(x.dtype)


def causal_attention(q, k, v):
    bsz, s, h, dqk = q.shape
    nb = s // Q_BLOCK
    qb = q.reshape(bsz, nb, Q_BLOCK, h, dqk).transpose(1, 0, 2, 3, 4)
    key_idx = jnp.arange(s)
    scale = dqk ** -0.5

    def block(args):
        q_blk, i = args
        sc = jnp.einsum('bqhd,bkhd->bhqk', q_blk, k,
                        preferred_element_type=jnp.float32) * scale
        q_idx = i * Q_BLOCK + jnp.arange(Q_BLOCK)
        sc = jnp.where(key_idx[None, :] <= q_idx[:, None], sc, -jnp.inf)
        p = jax.nn.softmax(sc, axis=-1).astype(v.dtype)
        return jnp.einsum('bhqk,bkhd->bqhd', p, v)

    out = lax.map(block, (qb, jnp.arange(nb)))
    return out.transpose(1, 0, 2, 3, 4).reshape(bsz, s, h, v.shape[-1])


def mla(x, positions, w_in, q_norm_g, w_q_up, kv_norm_g, w_kv_up, w_out):
    bsz, s, _ = x.shape
    h = x @ w_in
    c_q = h[..., :Q_LORA]
    c_kv = h[..., Q_LORA:Q_LORA + KV_LORA]
    k_rope = h[..., Q_LORA + KV_LORA:]
    q = (rms_norm(c_q, q_norm_g) @ w_q_up).reshape(bsz, s, MLA_HEADS, QK_NOPE + QK_ROPE)
    kv = (rms_norm(c_kv, kv_norm_g) @ w_kv_up).reshape(bsz, s, MLA_HEADS, QK_NOPE + V_HEAD)
    q_nope, q_rope = q[..., :QK_NOPE], q[..., QK_NOPE:]
    k_nope, v = kv[..., :QK_NOPE], kv[..., QK_NOPE:]
    freqs = ROPE_THETA ** (-jnp.arange(0, QK_ROPE, 2, dtype=jnp.float32) / QK_ROPE)
    ang = positions.astype(jnp.float32)[..., None] * freqs
    cos, sin = jnp.cos(ang), jnp.sin(ang)
    q_rope = apply_rope(q_rope, cos[:, :, None], sin[:, :, None])
    k_rope = apply_rope(k_rope, cos, sin)
    q = jnp.concatenate([q_nope, q_rope], axis=-1)
    k = jnp.concatenate([k_nope, jnp.broadcast_to(k_rope[:, :, None], (bsz, s, MLA_HEADS, QK_ROPE))], axis=-1)
    o = causal_attention(q, k, v)
    return o.reshape(bsz, s, MLA_HEADS * V_HEAD) @ w_out


def swiglu(x, w_gate_up, w_down):
    gu = x @ w_gate_up
    return (jax.nn.silu(gu[..., :D_FF]) * gu[..., D_FF:]) @ w_down


def setup_inputs(seed: int = 0) -> dict:
    key = jax.random.key(seed)
    ks = jax.random.split(key, 24)
    nrm = jax.random.normal
    f32 = jnp.float32
    x = nrm(ks[0], (BATCH, SEQ, D_MODEL), f32)
    offs = jax.random.randint(ks[1], (BATCH, 1), 0, 1024, dtype=jnp.int32)
    positions = jnp.arange(SEQ, dtype=jnp.int32)[None, :] + offs
    return {
        "x": x,
        "positions": positions,
        "even_w_in": nrm(ks[2], (N_EVEN, D_MODEL, EVEN_IN), f32) * D_MODEL ** -0.5,
        "even_vnorm_g": 1.0 + 0.1 * nrm(ks[3], (N_EVEN, GM_WIDTH), f32),
        "even_vnorm_b": 0.02 * nrm(ks[4], (N_EVEN, GM_WIDTH), f32),
        "even_spatial_w": nrm(ks[5], (N_EVEN, GM_HEADS, CHUNK, CHUNK), f32) * CHUNK ** -0.5,
        "even_spatial_b": 1.0 + 0.1 * nrm(ks[6], (N_EVEN, GM_HEADS, CHUNK), f32),
        "even_pool_w": nrm(ks[7], (N_EVEN, POOL_GROUPS, POOL_GROUP_DIM, POOL_GROUP_DIM), f32) * POOL_GROUP_DIM ** -0.5,
        "even_pool_scale": 1.0 + 0.1 * nrm(ks[8], (N_EVEN, POOL_WIDTH), f32),
        "even_w_out": nrm(ks[9], (N_EVEN, EVEN_MIX, D_MODEL), f32) * (EVEN_MIX ** -0.5 * BETA),
        "odd_w_in": nrm(ks[10], (N_ODD, D_MODEL, ODD_IN), f32) * D_MODEL ** -0.5,
        "odd_q_norm_g": 1.0 + 0.1 * nrm(ks[11], (N_ODD, Q_LORA), f32),
        "odd_w_q_up": nrm(ks[12], (N_ODD, Q_LORA, MLA_HEADS * (QK_NOPE + QK_ROPE)), f32) * Q_LORA ** -0.5,
        "odd_kv_norm_g": 1.0 + 0.1 * nrm(ks[13], (N_ODD, KV_LORA), f32),
        "odd_w_kv_up": nrm(ks[14], (N_ODD, KV_LORA, MLA_HEADS * (QK_NOPE + V_HEAD)), f32) * KV_LORA ** -0.5,
        "odd_w_out": nrm(ks[15], (N_ODD, MLA_HEADS * V_HEAD, D_MODEL), f32) * ((MLA_HEADS * V_HEAD) ** -0.5 * BETA),
        "mix_ln_g": 1.0 + 0.1 * nrm(ks[16], (DEPTH, D_MODEL), f32),
        "mix_ln_b": 0.02 * nrm(ks[17], (DEPTH, D_MODEL), f32),
        "ffn_w_gate_up": nrm(ks[18], (DEPTH, D_MODEL, 2 * D_FF), f32) * D_MODEL ** -0.5,
        "ffn_w_down": nrm(ks[19], (DEPTH, D_FF, D_MODEL), f32) * (D_FF ** -0.5 * BETA),
        "ffn_ln_g": 1.0 + 0.1 * nrm(ks[20], (DEPTH, D_MODEL), f32),
        "ffn_ln_b": 0.02 * nrm(ks[21], (DEPTH, D_MODEL), f32),
    }


def reference(x, positions, even_w_in, even_vnorm_g, even_vnorm_b, even_spatial_w,
              even_spatial_b, even_pool_w, even_pool_scale, even_w_out,
              odd_w_in, odd_q_norm_g, odd_w_q_up, odd_kv_norm_g, odd_w_kv_up, odd_w_out,
              mix_ln_g, mix_ln_b, ffn_w_gate_up, ffn_w_down, ffn_ln_g, ffn_ln_b):
    for layer in range(DEPTH):
        j = layer // 2
        if layer % 2 == 0:
            m = even_mixer(x, even_w_in[j], even_vnorm_g[j], even_vnorm_b[j], even_spatial_w[j],
                           even_spatial_b[j], even_pool_w[j], even_pool_scale[j], even_w_out[j])
        else:
            m = mla(x, positions, odd_w_in[j], odd_q_norm_g[j], odd_w_q_up[j],
                    odd_kv_norm_g[j], odd_w_kv_up[j], odd_w_out[j])
        x = layer_norm(ALPHA * x + m, mix_ln_g[layer], mix_ln_b[layer])
        x = layer_norm(ALPHA * x + swiglu(x, ffn_w_gate_up[layer], ffn_w_down[layer]),
                       ffn_ln_g[layer], ffn_ln_b[layer])
    return x
```

```cpp
#include <hip/hip_runtime.h>
#include <cstdio>
#include <cstdint>

constexpr int BATCH = 8, SEQ = 4096, T = BATCH * SEQ, DM = 1024;
constexpr int GMW = 512, GMH = 8, GHD = 64, CHUNK = 128;
constexpr int PW = 512, PG = 4, PGD = 128;
constexpr int EVEN_IN = 1536;
constexpr int MH = 16, QKN = 64, QKR = 32, VH = 64, QL = 384, KVL = 256, ODD_IN = 672;
constexpr int DQK = QKN + QKR;
constexpr int DFF = 2816;
constexpr float ALPHA = 1.4142135623730951f;
constexpr float LN_EPS = 1e-5f, RMS_EPS = 1e-6f;

typedef float f32x4 __attribute__((ext_vector_type(4)));

__global__ void __launch_bounds__(256) gemm_f32(const float* __restrict__ A, int lda, const float* __restrict__ B, int ldb,
                                                float* __restrict__ C, int ldc, int M, int N, int K) {
    __shared__ float As[16][132];
    __shared__ float Bs[16][132];
    const int tid = threadIdx.x, tx = tid & 15, ty = tid >> 4;
    const int m0 = blockIdx.y * 128, n0 = blockIdx.x * 128;
    float acc[8][8];
#pragma unroll
    for (int i = 0; i < 8; ++i)
#pragma unroll
        for (int j = 0; j < 8; ++j) acc[i][j] = 0.f;
    const int arow = tid >> 1, akq = (tid & 1) * 8;
    const int bk = tid >> 4, bn = (tid & 15) * 8;
    for (int k0 = 0; k0 < K; k0 += 16) {
        const float* ap = A + (size_t)(m0 + arow) * lda + k0 + akq;
        f32x4 a0 = *(const f32x4*)ap, a1 = *(const f32x4*)(ap + 4);
        f32x4 b0 = (f32x4){0.f, 0.f, 0.f, 0.f}, b1 = b0;
        const float* bp = B + (size_t)(k0 + bk) * ldb + n0 + bn;
        if (n0 + bn < N) b0 = *(const f32x4*)bp;
        if (n0 + bn + 4 < N) b1 = *(const f32x4*)(bp + 4);
        __syncthreads();
        As[akq + 0][arow] = a0[0]; As[akq + 1][arow] = a0[1]; As[akq + 2][arow] = a0[2]; As[akq + 3][arow] = a0[3];
        As[akq + 4][arow] = a1[0]; As[akq + 5][arow] = a1[1]; As[akq + 6][arow] = a1[2]; As[akq + 7][arow] = a1[3];
        *(f32x4*)&Bs[bk][bn] = b0; *(f32x4*)&Bs[bk][bn + 4] = b1;
        __syncthreads();
#pragma unroll
        for (int k = 0; k < 16; ++k) {
            const f32x4 x0 = *(const f32x4*)&As[k][ty * 4], x1 = *(const f32x4*)&As[k][64 + ty * 4];
            const f32x4 y0 = *(const f32x4*)&Bs[k][tx * 4], y1 = *(const f32x4*)&Bs[k][64 + tx * 4];
            const float xa[8] = {x0[0], x0[1], x0[2], x0[3], x1[0], x1[1], x1[2], x1[3]};
            const float yb[8] = {y0[0], y0[1], y0[2], y0[3], y1[0], y1[1], y1[2], y1[3]};
#pragma unroll
            for (int i = 0; i < 8; ++i)
#pragma unroll
                for (int j = 0; j < 8; ++j) acc[i][j] = fmaf(xa[i], yb[j], acc[i][j]);
        }
    }
#pragma unroll
    for (int i = 0; i < 8; ++i) {
        const int r = m0 + (i < 4 ? ty * 4 + i : 64 + ty * 4 + (i - 4));
#pragma unroll
        for (int jh = 0; jh < 2; ++jh) {
            const int c = n0 + jh * 64 + tx * 4;
            if (c < N) *(f32x4*)(C + (size_t)r * ldc + c) = (f32x4){acc[i][jh * 4 + 0], acc[i][jh * 4 + 1], acc[i][jh * 4 + 2], acc[i][jh * 4 + 3]};
        }
    }
}

__device__ __forceinline__ float wave_sum(float v) {
#pragma unroll
    for (int o = 1; o < 64; o <<= 1) v += __shfl_xor(v, o);
    return v;
}

__global__ void __launch_bounds__(256) ln_res_kernel(const float* xa, const float* __restrict__ m, const float* __restrict__ g,
                                                     const float* __restrict__ b, float* out, int rows) {
    const int row = blockIdx.x * 4 + (threadIdx.x >> 6), lane = threadIdx.x & 63;
    if (row >= rows) return;
    float v[16]; float s = 0.f;
#pragma unroll
    for (int j = 0; j < 4; ++j) {
        const f32x4 a = *(const f32x4*)(xa + (size_t)row * DM + j * 256 + lane * 4), c = *(const f32x4*)(m + (size_t)row * DM + j * 256 + lane * 4);
#pragma unroll
        for (int e = 0; e < 4; ++e) { v[j * 4 + e] = ALPHA * a[e] + c[e]; s += v[j * 4 + e]; }
    }
    const float mean = wave_sum(s) * (1.f / DM); float q = 0.f;
#pragma unroll
    for (int i = 0; i < 16; ++i) { v[i] -= mean; q += v[i] * v[i]; }
    const float rstd = 1.0f / sqrtf(wave_sum(q) * (1.f / DM) + LN_EPS);
#pragma unroll
    for (int j = 0; j < 4; ++j) {
        const f32x4 gg = *(const f32x4*)(g + j * 256 + lane * 4), bb = *(const f32x4*)(b + j * 256 + lane * 4);
        f32x4 o;
#pragma unroll
        for (int e = 0; e < 4; ++e) o[e] = v[j * 4 + e] * rstd * gg[e] + bb[e];
        *(f32x4*)(out + (size_t)row * DM + j * 256 + lane * 4) = o;
    }
}

__global__ void __launch_bounds__(256) even_prep_kernel(float* __restrict__ h0, const float* __restrict__ vg, const float* __restrict__ vb) {
    const int row = blockIdx.x * 4 + (threadIdx.x >> 6), lane = threadIdx.x & 63;
    float* hr = h0 + (size_t)row * EVEN_IN;
    float u[8], v[8];
#pragma unroll
    for (int j = 0; j < 2; ++j) {
        const f32x4 a = *(const f32x4*)(hr + j * 256 + lane * 4), c = *(const f32x4*)(hr + 512 + j * 256 + lane * 4);
#pragma unroll
        for (int e = 0; e < 4; ++e) {
            u[j * 4 + e] = 0.5f * a[e] * (1.f + erff(a[e] * 0.70710678118654752f));
            v[j * 4 + e] = 0.5f * c[e] * (1.f + erff(c[e] * 0.70710678118654752f));
        }
    }
    float s = 0.f;
#pragma unroll
    for (int i = 0; i < 8; ++i) s += v[i];
    const float mean = wave_sum(s) * (1.f / GMW); float q = 0.f;
#pragma unroll
    for (int i = 0; i < 8; ++i) { v[i] -= mean; q += v[i] * v[i]; }
    const float rstd = 1.0f / sqrtf(wave_sum(q) * (1.f / GMW) + LN_EPS);
#pragma unroll
    for (int j = 0; j < 2; ++j) {
        const f32x4 gg = *(const f32x4*)(vg + j * 256 + lane * 4), bb = *(const f32x4*)(vb + j * 256 + lane * 4);
        f32x4 ou, ov;
#pragma unroll
        for (int e = 0; e < 4; ++e) { ou[e] = u[j * 4 + e]; ov[e] = v[j * 4 + e] * rstd * gg[e] + bb[e]; }
        *(f32x4*)(hr + j * 256 + lane * 4) = ou; *(f32x4*)(hr + 512 + j * 256 + lane * 4) = ov;
    }
}

__global__ void __launch_bounds__(256) spatial_gate_kernel(const float* __restrict__ h0, const float* __restrict__ ws, const float* __restrict__ bs, float* __restrict__ mix) {
    const int d = threadIdx.x & 63, t = blockIdx.x * 4 + (threadIdx.x >> 6), h = blockIdx.y;
    const int tt = t & (CHUNK - 1), c0 = t - tt;
    const float* w = ws + ((size_t)h * CHUNK + tt) * CHUNK;
    float acc = 0.f;
    for (int s = 0; s <= tt; ++s) acc = fmaf(w[s], h0[(size_t)(c0 + s) * EVEN_IN + GMW + h * GHD + d], acc);
    acc += bs[h * CHUNK + tt];
    mix[(size_t)t * DM + h * GHD + d] = h0[(size_t)t * EVEN_IN + h * GHD + d] * acc;
}

__global__ void __launch_bounds__(256) pool_kernel(const float* __restrict__ h0, float* __restrict__ pooled) {
    const int col = (blockIdx.x & 1) * 256 + threadIdx.x, t = blockIdx.x >> 1;
    const int g = col >> 7, w = 2 << g, tpos = t & (SEQ - 1);
    const int cnt = (tpos + 1 < w) ? tpos + 1 : w;
    float s = 0.f;
    for (int j = 0; j < cnt; ++j) s += h0[(size_t)(t - j) * EVEN_IN + 2 * GMW + col];
    pooled[(size_t)t * PW + col] = s / (float)cnt - h0[(size_t)t * EVEN_IN + 2 * GMW + col];
}
__global__ void __launch_bounds__(256) pool_mix_kernel(const float* __restrict__ pooled, const float* __restrict__ wp, const float* __restrict__ scale, float* __restrict__ mix) {
    const int col = (blockIdx.x & 1) * 256 + threadIdx.x, t = blockIdx.x >> 1;
    const int g = col >> 7, d = col & 127;
    const float* p = pooled + (size_t)t * PW + g * PGD; const float* w = wp + (size_t)g * PGD * PGD + d;
    float acc = 0.f;
    for (int c = 0; c < PGD; ++c) acc = fmaf(p[c], w[(size_t)c * PGD], acc);
    mix[(size_t)t * DM + GMW + col] = acc * scale[col];
}

__global__ void __launch_bounds__(256) swiglu_kernel(const float* __restrict__ gu, float* __restrict__ hff, int rows) {
    const size_t i = (size_t)blockIdx.x * 256 + threadIdx.x;
    if (i >= (size_t)rows * DFF) return;
    const int r = (int)(i / DFF), c = (int)(i % DFF);
    const float g = gu[(size_t)r * 2 * DFF + c], u = gu[(size_t)r * 2 * DFF + DFF + c];
    hff[i] = g / (1.f + expf(-g)) * u;
}

__device__ __forceinline__ void rope_cs(int pos, int i, float& c, float& s) {
    const float freq = exp2f(-(float)(2 * i) * (1.0f / 32.0f) * 13.287712379549449f);
    const float ang = (float)pos * freq;
    double tr = (double)ang * 0.15915494309189535; tr -= __builtin_rint(tr);
    const float tf = (float)tr;
    s = __builtin_amdgcn_sinf(tf); c = __builtin_amdgcn_cosf(tf);
}

__global__ void __launch_bounds__(256) mla_prep_kernel(const float* __restrict__ h1, const int* __restrict__ pos, const float* __restrict__ qg, const float* __restrict__ kvg,
                                                       float* __restrict__ cqn, float* __restrict__ ckvn, float* __restrict__ krope) {
    const int row = blockIdx.x * 4 + (threadIdx.x >> 6), lane = threadIdx.x & 63;
    const float* hr = h1 + (size_t)row * ODD_IN;
    float a[6], b[4]; float sa = 0.f, sb = 0.f;
#pragma unroll
    for (int j = 0; j < 6; ++j) { a[j] = hr[j * 64 + lane]; sa += a[j] * a[j]; }
#pragma unroll
    for (int j = 0; j < 4; ++j) { b[j] = hr[QL + j * 64 + lane]; sb += b[j] * b[j]; }
    const float ra = 1.0f / sqrtf(wave_sum(sa) * (1.f / QL) + RMS_EPS), rb = 1.0f / sqrtf(wave_sum(sb) * (1.f / KVL) + RMS_EPS);
#pragma unroll
    for (int j = 0; j < 6; ++j) cqn[(size_t)row * QL + j * 64 + lane] = a[j] * ra * qg[j * 64 + lane];
#pragma unroll
    for (int j = 0; j < 4; ++j) ckvn[(size_t)row * KVL + j * 64 + lane] = b[j] * rb * kvg[j * 64 + lane];
    if (lane < 16) {
        const float x1 = hr[QL + KVL + lane], x2 = hr[QL + KVL + 16 + lane]; float c, s; rope_cs(pos[row], lane, c, s);
        krope[(size_t)row * QKR + lane] = x1 * c - x2 * s; krope[(size_t)row * QKR + 16 + lane] = x1 * s + x2 * c;
    }
}
__global__ void __launch_bounds__(256) q_rope_kernel(float* __restrict__ q, const int* __restrict__ pos, int row0) {
    const int i = threadIdx.x & 15, h = threadIdx.x >> 4, r = blockIdx.x;
    float* p = q + (size_t)r * (MH * DQK) + h * DQK + QKN;
    const float x1 = p[i], x2 = p[16 + i]; float c, s; rope_cs(pos[row0 + r], i, c, s);
    p[i] = x1 * c - x2 * s; p[16 + i] = x1 * s + x2 * c;
}

__global__ void __launch_bounds__(64) attn_naive_kernel(const float* __restrict__ q, const float* __restrict__ kv, const float* __restrict__ krope, float* __restrict__ o) {
    __shared__ float Ks[64][DQK];
    __shared__ float Vs[64][VH];
    const int qb = (gridDim.x - 1) - blockIdx.x, h = blockIdx.y, tid = threadIdx.x;
    const int qi = qb * 64 + tid;
    float qr[DQK], oa[VH];
    const float scale = 0.10206207261596575f;
#pragma unroll
    for (int d = 0; d < DQK; d += 4) { const f32x4 v = *(const f32x4*)(q + (size_t)qi * (MH * DQK) + h * DQK + d); qr[d] = v[0] * scale; qr[d + 1] = v[1] * scale; qr[d + 2] = v[2] * scale; qr[d + 3] = v[3] * scale; }
#pragma unroll
    for (int d = 0; d < VH; ++d) oa[d] = 0.f;
    float mrun = -1e30f, l = 0.f;
    for (int kt = 0; kt <= qb; ++kt) {
        __syncthreads();
        {
            const int kj = kt * 64 + tid;
            const float* kp = kv + (size_t)kj * (MH * 128) + h * 128;
#pragma unroll
            for (int d = 0; d < QKN; d += 4) *(f32x4*)&Ks[tid][d] = *(const f32x4*)(kp + d);
#pragma unroll
            for (int d = 0; d < QKR; d += 4) *(f32x4*)&Ks[tid][QKN + d] = *(const f32x4*)(krope + (size_t)kj * QKR + d);
#pragma unroll
            for (int d = 0; d < VH; d += 4) *(f32x4*)&Vs[tid][d] = *(const f32x4*)(kp + QKN + d);
        }
        __syncthreads();
        for (int j0 = 0; j0 < 64; j0 += 16) {
            float s[16]; float mx = mrun;
#pragma unroll
            for (int jj = 0; jj < 16; ++jj) {
                float a = 0.f;
#pragma unroll
                for (int d = 0; d < DQK; d += 4) { const f32x4 kk = *(const f32x4*)&Ks[j0 + jj][d]; a = fmaf(qr[d], kk[0], a); a = fmaf(qr[d + 1], kk[1], a); a = fmaf(qr[d + 2], kk[2], a); a = fmaf(qr[d + 3], kk[3], a); }
                if (kt * 64 + j0 + jj > qi) a = -INFINITY;
                s[jj] = a; mx = fmaxf(mx, a);
            }
            const float corr = expf(mrun - mx); mrun = mx; l *= corr;
#pragma unroll
            for (int d = 0; d < VH; ++d) oa[d] *= corr;
#pragma unroll
            for (int jj = 0; jj < 16; ++jj) {
                const float p = expf(s[jj] - mx); l += p;
#pragma unroll
                for (int d = 0; d < VH; d += 4) { const f32x4 vv = *(const f32x4*)&Vs[j0 + jj][d]; oa[d] = fmaf(p, vv[0], oa[d]); oa[d + 1] = fmaf(p, vv[1], oa[d + 1]); oa[d + 2] = fmaf(p, vv[2], oa[d + 2]); oa[d + 3] = fmaf(p, vv[3], oa[d + 3]); }
            }
        }
    }
    const float rl = 1.f / l;
#pragma unroll
    for (int d = 0; d < VH; d += 4) *(f32x4*)(o + (size_t)qi * (MH * VH) + h * VH + d) = (f32x4){oa[d] * rl, oa[d + 1] * rl, oa[d + 2] * rl, oa[d + 3] * rl};
}

static void gemm(hipStream_t st, const float* A, int lda, const float* B, int ldb, float* C, int ldc, int M, int N, int K) {
    dim3 grid((N + 127) / 128, M / 128);
    hipLaunchKernelGGL(gemm_f32, grid, dim3(256), 0, st, A, lda, B, ldb, C, ldc, M, N, K);
}

extern "C" void kernel_launch(void* const* d_in, const int* in_sizes, int n_in, void* d_out, int out_size, void* d_ws, size_t ws_size, hipStream_t stream) {
    const float* x = (const float*)d_in[0]; const int* positions = (const int*)d_in[1];
    const float* even_w_in = (const float*)d_in[2]; const float* even_vg = (const float*)d_in[3]; const float* even_vb = (const float*)d_in[4];
    const float* even_sw = (const float*)d_in[5]; const float* even_sb = (const float*)d_in[6]; const float* even_pw = (const float*)d_in[7];
    const float* even_ps = (const float*)d_in[8]; const float* even_w_out = (const float*)d_in[9];
    const float* odd_w_in = (const float*)d_in[10]; const float* odd_qg = (const float*)d_in[11]; const float* odd_wq = (const float*)d_in[12];
    const float* odd_kvg = (const float*)d_in[13]; const float* odd_wkv = (const float*)d_in[14]; const float* odd_w_out = (const float*)d_in[15];
    const float* mix_g = (const float*)d_in[16]; const float* mix_b = (const float*)d_in[17];
    const float* ffn_gu = (const float*)d_in[18]; const float* ffn_dn = (const float*)d_in[19];
    const float* ffn_g = (const float*)d_in[20]; const float* ffn_b = (const float*)d_in[21];
    float* out = (float*)d_out;
    char* ws = (char*)d_ws;
    const size_t MB = 1u << 20;
    float* W0 = (float*)(ws);
    float* W1 = (float*)(ws + 256 * MB);
    float* W2 = (float*)(ws + 384 * MB);

    float* h0 = W0;
    gemm(stream, x, DM, even_w_in, EVEN_IN, h0, EVEN_IN, T, EVEN_IN, DM);
    hipLaunchKernelGGL(even_prep_kernel, dim3(T / 4), dim3(256), 0, stream, h0, even_vg, even_vb);
    float* mix = W1;
    hipLaunchKernelGGL(spatial_gate_kernel, dim3(T / 4, GMH), dim3(256), 0, stream, h0, even_sw, even_sb, mix);
    float* pooled = W2;
    hipLaunchKernelGGL(pool_kernel, dim3(T * 2), dim3(256), 0, stream, h0, pooled);
    hipLaunchKernelGGL(pool_mix_kernel, dim3(T * 2), dim3(256), 0, stream, pooled, even_pw, even_ps, mix);
    float* m = W0;
    gemm(stream, mix, DM, even_w_out, DM, m, DM, T, DM, DM);
    hipLaunchKernelGGL(ln_res_kernel, dim3(T / 4), dim3(256), 0, stream, x, m, mix_g, mix_b, out, T);
    for (int c = 0; c < 4; ++c) {
        const int r0 = c * 8192;
        gemm(stream, out + (size_t)r0 * DM, DM, ffn_gu, 2 * DFF, W0, 2 * DFF, 8192, 2 * DFF, DM);
        hipLaunchKernelGGL(swiglu_kernel, dim3((unsigned)(((size_t)8192 * DFF + 255) / 256)), dim3(256), 0, stream, W0, W1, 8192);
        gemm(stream, W1, DFF, ffn_dn, DM, W2 + (size_t)r0 * DM, DM, 8192, DM, DFF);
    }
    hipLaunchKernelGGL(ln_res_kernel, dim3(T / 4), dim3(256), 0, stream, out, W2, ffn_g, ffn_b, out, T);

    float* h1 = W2;
    gemm(stream, out, DM, odd_w_in, ODD_IN, h1, ODD_IN, T, ODD_IN, DM);
    float* cqn = W1;
    float* ckvn = W1 + (size_t)T * QL;
    float* krope = ckvn + (size_t)T * KVL;
    hipLaunchKernelGGL(mla_prep_kernel, dim3(T / 4), dim3(256), 0, stream, h1, positions, odd_qg, odd_kvg, cqn, ckvn, krope);
    float* ob = W0;
    float* qb = W0 + (size_t)T * DM;
    float* kvb = qb + (size_t)SEQ * MH * DQK;
    for (int b = 0; b < BATCH; ++b) {
        const int r0 = b * SEQ;
        gemm(stream, cqn + (size_t)r0 * QL, QL, odd_wq, MH * DQK, qb, MH * DQK, SEQ, MH * DQK, QL);
        hipLaunchKernelGGL(q_rope_kernel, dim3(SEQ), dim3(256), 0, stream, qb, positions, r0);
        gemm(stream, ckvn + (size_t)r0 * KVL, KVL, odd_wkv, MH * 128, kvb, MH * 128, SEQ, MH * 128, KVL);
        hipLaunchKernelGGL(attn_naive_kernel, dim3(SEQ / 64, MH), dim3(64), 0, stream, qb, kvb, krope + (size_t)r0 * QKR, ob + (size_t)r0 * DM);
    }
    float* m1 = W2;
    gemm(stream, ob, DM, odd_w_out, DM, m1, DM, T, DM, DM);
    hipLaunchKernelGGL(ln_res_kernel, dim3(T / 4), dim3(256), 0, stream, out, m1, mix_g + DM, mix_b + DM, out, T);
    for (int c = 0; c < 4; ++c) {
        const int r0 = c * 8192;
        gemm(stream, out + (size_t)r0 * DM, DM, ffn_gu + (size_t)DM * 2 * DFF, 2 * DFF, W0, 2 * DFF, 8192, 2 * DFF, DM);
        hipLaunchKernelGGL(swiglu_kernel, dim3((unsigned)(((size_t)8192 * DFF + 255) / 256)), dim3(256), 0, stream, W0, W1, 8192);
        gemm(stream, W1, DFF, ffn_dn + (size_t)DFF * DM, DM, W2 + (size_t)r0 * DM, DM, 8192, DM, DFF);
    }
    hipLaunchKernelGGL(ln_res_kernel, dim3(T / 4), dim3(256), 0, stream, out, W2, ffn_g + DM, ffn_b + DM, out, T);
}
```
